# Optimizing an MI355X kernel written in HIP

```python
import jax, jax.numpy as jnp
from jax import lax
import numpy as np

D_MODEL = 1024
BATCH = 4
SEQ = 4096
DEPTH = 1
DEC_BATCH = 1
DEC_SEQ = 16384
PAST_LEN = 128

GRID_W = 64
N_HEADS = 8
N_KV_HEADS = 2
HEAD_DIM = 128
GROUP = N_HEADS // N_KV_HEADS
ATTN_WIDTH = N_HEADS * HEAD_DIM
KV_WIDTH = N_KV_HEADS * HEAD_DIM
ROPE_HALF = HEAD_DIM // 2
ROPE_THETA = 10000.0
Q_BLOCK = 128
CONV_WIDTH = D_MODEL
CONV_GROUPS = 16
CONV_K = 3
N_BRANCH = 2
BRANCH_WIDTH = 1024
FF_HIDDEN = -(-8 * D_MODEL // (3 * 256)) * 256
EPS = 1e-6

IN_SPLITS = (CONV_WIDTH, CONV_WIDTH, CONV_WIDTH, ATTN_WIDTH, KV_WIDTH, KV_WIDTH)
IN_WIDTH = sum(IN_SPLITS) + N_BRANCH * D_MODEL
IN_OFFSETS = tuple(int(v) for v in np.cumsum(IN_SPLITS))

kernel_name = "hybrid_gated_conv_axial_gqa_encoder"


def rmsnorm(x, g):
    xf = x.astype(jnp.float32)
    y = xf * lax.rsqrt(jnp.mean(xf * xf, axis=-1, keepdims=True) + EPS)
    return (y * g.astype(jnp.float32)).astype(x.dtype)


def axial_rope_angles(seq_len):
    n_rows = seq_len // GRID_W
    rows = jnp.repeat(jnp.arange(n_rows, dtype=jnp.float32), GRID_W)
    cols = jnp.tile(jnp.arange(GRID_W, dtype=jnp.float32), n_rows)
    inv_freq = ROPE_THETA ** (-jnp.arange(0, ROPE_HALF, 2, dtype=jnp.float32) / ROPE_HALF)
    ang = jnp.concatenate([rows[:, None] * inv_freq[None, :], cols[:, None] * inv_freq[None, :]], axis=-1)
    return jnp.cos(ang), jnp.sin(ang)


def apply_rope(x, cos, sin):
    b, s, h, d = x.shape
    xp = x.astype(jnp.float32).reshape(b, s, h, d // 2, 2)
    x0, x1 = xp[..., 0], xp[..., 1]
    c = cos[None, :, None, :]
    sn = sin[None, :, None, :]
    out = jnp.stack([x0 * c - x1 * sn, x0 * sn + x1 * c], axis=-1)
    return out.reshape(b, s, h, d).astype(x.dtype)


def centred_depthwise_conv(u, w):
    return lax.conv_general_dilated(
        u, w[:, None, :].astype(u.dtype), window_strides=(1,), padding=[(1, 1)],
        dimension_numbers=("NWC", "WIO", "NWC"), feature_group_count=u.shape[-1])


def gqa_attention(q, k, v):
    b, s = q.shape[0], q.shape[1]
    nb = s // Q_BLOCK
    scale = HEAD_DIM ** -0.5
    qb = q.reshape(b, nb, Q_BLOCK, N_KV_HEADS, GROUP, HEAD_DIM).transpose(1, 0, 2, 3, 4, 5)

    def block(q_blk):
        sc = jnp.einsum("bqkgd,bskd->bkgqs", q_blk, k).astype(jnp.float32) * scale
        p = jax.nn.softmax(sc, axis=-1).astype(v.dtype)
        return jnp.einsum("bkgqs,bskd->bqkgd", p, v)

    out = lax.map(block, qb)
    return out.transpose(1, 0, 2, 3, 4, 5).reshape(b, s, ATTN_WIDTH)


def mixer(xn, w_in, conv_w, q_norm_g, k_norm_g, w_branch, w_out, cos, sin):
    b, s, _ = xn.shape
    proj = xn @ w_in
    c_b, c_c, c_x, q, k, v, gates = jnp.split(proj, IN_OFFSETS, axis=-1)
    y_conv = c_b * centred_depthwise_conv(c_c * c_x, conv_w)
    q = apply_rope(rmsnorm(q.reshape(b, s, N_HEADS, HEAD_DIM), q_norm_g), cos, sin)
    k = apply_rope(rmsnorm(k.reshape(b, s, N_KV_HEADS, HEAD_DIM), k_norm_g), cos, sin)
    v = v.reshape(b, s, N_KV_HEADS, HEAD_DIM)
    y_attn = gqa_attention(q, k, v)
    branches = jnp.stack([y_conv, y_attn], axis=2)
    br = jnp.einsum("bsnc,ncd->bsnd", branches, w_branch)
    g = jax.nn.sigmoid(gates.reshape(b, s, N_BRANCH, D_MODEL))
    merged = jnp.sum(g * br, axis=2)
    return merged @ w_out


def swiglu(xn, w_ffn_in, w_ffn_out):
    gate, up = jnp.split(xn @ w_ffn_in, 2, axis=-1)
    return (jax.nn.silu(gate) * up) @ w_ffn_out


def trunk(x, norm_mix_g, w_in, conv_w, q_norm_g, k_norm_g, w_branch, w_out,
          norm_ffn_g, w_ffn_in, w_ffn_out, norm_final_g):
    cos, sin = axial_rope_angles(x.shape[1])
    for l in range(DEPTH):
        x = x + mixer(rmsnorm(x, norm_mix_g[l]), w_in[l], conv_w[l], q_norm_g[l], k_norm_g[l],
                      w_branch[l], w_out[l], cos, sin)
        x = x + swiglu(rmsnorm(x, norm_ffn_g[l]), w_ffn_in[l], w_ffn_out[l])
    return rmsnorm(x, norm_final_g)


def setup_inputs(seed: int = 0) -> dict:
    key = jax.random.key(seed)
    ks = jax.random.split(key, 13)
    f32 = jnp.float32

    def nrm(k, shape, scale):
        return jax.random.normal(k, shape, f32) * scale

    def gain(k, shape):
        return 1.0 + 0.02 * jax.random.normal(k, shape, f32)

    return {
        "x_prompt": jax.random.normal(ks[0], (BATCH, SEQ, D_MODEL), f32),
        "x_sample": jax.random.normal(ks[1], (DEC_BATCH, DEC_SEQ, D_MODEL), f32),
        "norm_mix_g": gain(ks[2], (DEPTH, D_MODEL)),
        "w_in": nrm(ks[3], (DEPTH, D_MODEL, IN_WIDTH), D_MODEL ** -0.5),
        "conv_w": nrm(ks[4], (DEPTH, CONV_K, CONV_WIDTH), CONV_K ** -0.5),
        "q_norm_g": gain(ks[5], (DEPTH, HEAD_DIM)),
        "k_norm_g": gain(ks[6], (DEPTH, HEAD_DIM)),
        "w_branch": nrm(ks[7], (DEPTH, N_BRANCH, BRANCH_WIDTH, D_MODEL), BRANCH_WIDTH ** -0.5),
        "w_out": nrm(ks[8], (DEPTH, D_MODEL, D_MODEL), D_MODEL ** -0.5),
        "norm_ffn_g": gain(ks[9], (DEPTH, D_MODEL)),
        "w_ffn_in": nrm(ks[10], (DEPTH, D_MODEL, 2 * FF_HIDDEN), D_MODEL ** -0.5),
        "w_ffn_out": nrm(ks[11], (DEPTH, FF_HIDDEN, D_MODEL), FF_HIDDEN ** -0.5),
        "norm_final_g": gain(ks[12], (D_MODEL,)),
    }


def reference(x_prompt, x_sample, norm_mix_g, w_in, conv_w, q_norm_g, k_norm_g, w_branch, w_out,
              norm_ffn_g, w_ffn_in, w_ffn_out, norm_final_g):
    y_prompt = trunk(x_prompt, norm_mix_g, w_in, conv_w, q_norm_g, k_norm_g, w_branch, w_out,
                     norm_ffn_g, w_ffn_in, w_ffn_out, norm_final_g)
    y_sample = trunk(x_sample, norm_mix_g, w_in, conv_w, q_norm_g, k_norm_g, w_branch, w_out,
                     norm_ffn_g, w_ffn_in, w_ffn_out, norm_final_g)
    return (y_prompt, y_sample)
```

```cpp
#include <hip/hip_runtime.h>
#include <hip/hip_cooperative_groups.h>
#include <hip/hip_bf16.h>
#include <cstdio>
#include <cstdint>
namespace cg = cooperative_groups;
#define MK_LAUNCHES 13
namespace pg8 {
#define PG8_LAS __attribute__((address_space(3)))
typedef unsigned short bf16_t;
typedef short bf16x8 __attribute__((ext_vector_type(8)));
typedef float f32x4 __attribute__((ext_vector_type(4)));
typedef unsigned u32x4 __attribute__((ext_vector_type(4)));
constexpr int BM = 256, BK = 64, HALF = 128, HTB = HALF * BK * 2  , STAGE_BYTES = 8 * HTB, NXCD = 8, WGM = 8;

__host__ __device__ __forceinline__ int lds_byte(int r, int c) { const int st = (r >> 4) * 2 + (c >> 5), rr = r & 15, cc = c & 31, ob = rr * 64 + cc * 2; return st * 1024 + (ob ^ (((ob >> 9) & 1) << 5)); }
__host__ __device__ __forceinline__ void stage_rc(int b, int& R, int& C) { const int st = b / 1024, sb = b % 1024, swz = sb ^ (((sb >> 9) & 1) << 5); R = (st >> 1) * 16 + swz / 64; C = (st & 1) * 32 + (swz % 64) / 2; }
__host__ __device__ __forceinline__ int perm32(int rho) { const int n = rho >> 4, i = rho & 15; return 8 * (i >> 2) + 4 * n + (i & 3); }

struct Unit { int pm, pn; };
struct Gemm { const bf16_t* A; const bf16_t* Bt; int M, N, K; };

struct StaticOrder {
    int nM, nN, nwg, G, c;
    __host__ __device__ void init(int M, int N, int G_, int c_) { nM = M / BM; nN = N / BM; nwg = nM * nN; G = G_; c = c_; }
    __host__ __device__ bool next(int i, Unit& u) const {
        const long L = (long)i * G + c; if (L >= nwg) return false;
        int wgid = (int)L; { const int q = nwg / NXCD, r = nwg % NXCD, xcd = wgid % NXCD, off = wgid / NXCD; wgid = (xcd < r ? xcd * (q + 1) : r * (q + 1) + (xcd - r) * q) + off; }
        const int nig = WGM * nN, gid = wgid / nig, fm = gid * WGM, gsz = (nM - fm) < WGM ? (nM - fm) : WGM;
        u.pm = fm + ((wgid % nig) % gsz); u.pn = (wgid % nig) / gsz; return true;
    }
    __device__ __forceinline__ void a_ready(const Unit&) const {}
    __device__ __forceinline__ void done(const Unit&) const {}
};

typedef float f32x2 __attribute__((ext_vector_type(2)));
typedef __bf16 bf16x2_t __attribute__((ext_vector_type(2)));
__device__ __forceinline__ unsigned cvt_pk_bf16(float lo, float hi) { f32x2 v = {lo, hi}; bf16x2_t b = __builtin_convertvector(v, bf16x2_t); return __builtin_bit_cast(unsigned, b); }
__device__ __forceinline__ void st8(bf16_t* p, f32x4 v0, f32x4 v1) {
    u32x4 w; w.x = cvt_pk_bf16(v0[0], v0[1]); w.y = cvt_pk_bf16(v0[2], v0[3]); w.z = cvt_pk_bf16(v1[0], v1[1]); w.w = cvt_pk_bf16(v1[2], v1[3]); *(u32x4*)p = w;
}
__device__ __forceinline__ void ld8(const bf16_t* p, f32x4& v0, f32x4& v1) {
    const u32x4 w = *(const u32x4*)p;
    v0[0] = __uint_as_float(w.x << 16); v0[1] = __uint_as_float(w.x & 0xffff0000u); v0[2] = __uint_as_float(w.y << 16); v0[3] = __uint_as_float(w.y & 0xffff0000u);
    v1[0] = __uint_as_float(w.z << 16); v1[1] = __uint_as_float(w.z & 0xffff0000u); v1[2] = __uint_as_float(w.w << 16); v1[3] = __uint_as_float(w.w & 0xffff0000u);
}
__device__ __forceinline__ float sigm(float v) { return __builtin_amdgcn_rcpf(1.f + __builtin_amdgcn_exp2f(-1.4426950408889634f * v)); }
__device__ __forceinline__ f32x4 sigm4(f32x4 v) { return (f32x4){sigm(v[0]), sigm(v[1]), sigm(v[2]), sigm(v[3])}; }

template <int ACT> __device__ __forceinline__ void store_tile(const f32x4 (&acc)[2][2][4][2], bf16_t* base, int ld, int row0, int col0) {
#pragma unroll
    for (int ai = 0; ai < 2; ++ai)
#pragma unroll
        for (int m = 0; m < 4; ++m) { bf16_t* rowp = base + (size_t)(row0 + ai * HALF + m * 16) * ld + col0;
#pragma unroll
            for (int bj = 0; bj < 2; ++bj) { f32x4 v0 = acc[ai][bj][m][0], v1 = acc[ai][bj][m][1];
                if (ACT == 1) { v0 = sigm4(v0); v1 = sigm4(v1); }
                st8(rowp + bj * HALF, v0, v1); } }
}
struct Epi1a { static constexpr bool PERM = true, AFTER_DRAIN = false;
    bf16_t *U, *CB, *G;
    __device__ __forceinline__ void operator()(const f32x4 (&acc)[2][2][4][2], const Unit& u, int wr, int wc, int fr, int fq) const {
        const int row0 = u.pm * BM + wr * 64 + fr, cq = wc * 32 + 8 * fq;
        if (u.pn < 8) {
#pragma unroll
            for (int ai = 0; ai < 2; ++ai)
#pragma unroll
                for (int m = 0; m < 4; ++m) { bf16_t* p = U + (size_t)(row0 + ai * HALF + m * 16) * 1024 + u.pn * 128 + cq;
                    st8(p, acc[ai][0][m][0] * acc[ai][1][m][0], acc[ai][0][m][1] * acc[ai][1][m][1]); }
        } else if (u.pn < 12) store_tile<0>(acc, CB, 1024, row0, (u.pn - 8) * 256 + cq);
        else store_tile<1>(acc, G, 1024, row0, (u.pn - 12) * 256 + cq);
    }
};
struct Epi1b { static constexpr bool PERM = true, AFTER_DRAIN = false;
    bf16_t *Q, *K, *V, *G;
    __device__ __forceinline__ void operator()(const f32x4 (&acc)[2][2][4][2], const Unit& u, int wr, int wc, int fr, int fq) const {
        const int row0 = u.pm * BM + wr * 64 + fr, cq = wc * 32 + 8 * fq;
        if (u.pn < 4) store_tile<0>(acc, Q, 1024, row0, u.pn * 256 + cq);
        else if (u.pn == 4) store_tile<0>(acc, K, 256, row0, cq);
        else if (u.pn == 5) store_tile<0>(acc, V, 256, row0, cq);
        else store_tile<1>(acc, G, 1024, row0, (u.pn - 6) * 256 + cq);
    }
};
template <int SECOND> struct EpiBranch { static constexpr bool PERM = true, AFTER_DRAIN = false;
    const bf16_t* G; bf16_t* MRG;
    __device__ __forceinline__ void operator()(const f32x4 (&acc)[2][2][4][2], const Unit& u, int wr, int wc, int fr, int fq) const {
        const int row0 = u.pm * BM + wr * 64 + fr, col0 = u.pn * BM + wc * 32 + 8 * fq;
#pragma unroll
        for (int ai = 0; ai < 2; ++ai)
#pragma unroll
            for (int m = 0; m < 4; ++m)
#pragma unroll
                for (int bj = 0; bj < 2; ++bj) { const size_t off = (size_t)(row0 + ai * HALF + m * 16) * 1024 + col0 + bj * HALF;
                    f32x4 g0, g1; ld8(G + off, g0, g1); f32x4 v0 = acc[ai][bj][m][0] * g0, v1 = acc[ai][bj][m][1] * g1;
                    if (SECOND) { f32x4 t0, t1; ld8(MRG + off, t0, t1); v0 += t0; v1 += t1; }
                    st8(MRG + off, v0, v1); }
    }
};
struct EpiRes1 { static constexpr bool PERM = true, AFTER_DRAIN = false;
    const float* xp; const float* xs; float* out; bf16_t* XB; float* ss;
    __device__ __forceinline__ void operator()(const f32x4 (&acc)[2][2][4][2], const Unit& u, int wr, int wc, int fr, int fq) const {
        const int row0 = u.pm * BM + wr * 64 + fr, col0 = u.pn * BM + wc * 32 + 8 * fq;
#pragma unroll
        for (int ai = 0; ai < 2; ++ai)
#pragma unroll
            for (int m = 0; m < 4; ++m) { const int row = row0 + ai * HALF + m * 16;
                const float* xr = (row < 16384) ? xp + (size_t)row * 1024 : xs + (size_t)(row - 16384) * 1024; float s = 0.f;
#pragma unroll
                for (int bj = 0; bj < 2; ++bj) { const int c = col0 + bj * HALF; const size_t off = (size_t)row * 1024 + c;
                    const f32x4 v0 = *(const f32x4*)(xr + c) + acc[ai][bj][m][0], v1 = *(const f32x4*)(xr + c + 4) + acc[ai][bj][m][1];
                    *(f32x4*)(out + off) = v0; *(f32x4*)(out + off + 4) = v1; st8(XB + off, v0, v1);
                    s += (v0[0] * v0[0] + v0[1] * v0[1]) + (v0[2] * v0[2] + v0[3] * v0[3]) + (v1[0] * v1[0] + v1[1] * v1[1]) + (v1[2] * v1[2] + v1[3] * v1[3]); }
                s += __shfl_xor(s, 16); s += __shfl_xor(s, 32);
                if (fq == 0) atomicAdd(ss + row, s); }
    }
};
struct EpiSwiglu { static constexpr bool PERM = true, AFTER_DRAIN = false;
    const float* ss; bf16_t* H;
    __device__ __forceinline__ void operator()(const f32x4 (&acc)[2][2][4][2], const Unit& u, int wr, int wc, int fr, int fq) const {
        const int row0 = u.pm * BM + wr * 64 + fr, cq = wc * 32 + 8 * fq;
#pragma unroll
        for (int ai = 0; ai < 2; ++ai)
#pragma unroll
            for (int m = 0; m < 4; ++m) { const int row = row0 + ai * HALF + m * 16;
                const float rstd = 1.0f / sqrtf(ss[row] * (1.0f / 1024.0f) + 1e-6f);
                f32x4 h[2];
#pragma unroll
                for (int n = 0; n < 2; ++n) { const f32x4 g = acc[ai][0][m][n] * rstd, up = acc[ai][1][m][n] * rstd; h[n] = g * sigm4(g) * up; }
                st8(H + (size_t)row * 2816 + u.pn * 128 + cq, h[0], h[1]); }
    }
};
struct EpiRes2 { static constexpr bool PERM = true, AFTER_DRAIN = false;
    float* out;
    __device__ __forceinline__ void operator()(const f32x4 (&acc)[2][2][4][2], const Unit& u, int wr, int wc, int fr, int fq) const {
        const int row0 = u.pm * BM + wr * 64 + fr, col0 = u.pn * BM + wc * 32 + 8 * fq;
#pragma unroll
        for (int ai = 0; ai < 2; ++ai)
#pragma unroll
            for (int m = 0; m < 4; ++m)
#pragma unroll
                for (int bj = 0; bj < 2; ++bj) { float* p = out + (size_t)(row0 + ai * HALF + m * 16) * 1024 + col0 + bj * HALF;
                    const f32x4 v0 = *(const f32x4*)p + acc[ai][bj][m][0], v1 = *(const f32x4*)(p + 4) + acc[ai][bj][m][1];
                    *(f32x4*)p = v0; *(f32x4*)(p + 4) = v1; }
    }
};
template <class Epi, class Sched, bool ALIGN_EPI = false, bool SP2 = false>
__device__ __forceinline__ void gemm_phase(PG8_LAS unsigned char* lds, const Gemm g, const Sched& S, const Epi& E) {
    const int tid = threadIdx.x, wid = __builtin_amdgcn_readfirstlane(tid >> 6), lane = tid & 63, wr = wid >> 2, wc = wid & 3, fr = lane & 15, fq = lane >> 4;
    const int K = g.K, nt = K / BK;
    unsigned voffA[2], voffB[2];
#pragma unroll
    for (int i = 0; i < 2; ++i) { int R, C; stage_rc(tid * 16 + i * 8192, R, C); const int Rb = Epi::PERM ? ((R & ~31) + perm32(R & 31)) : R;
        voffA[i] = (unsigned)(R * K + C) * 2u; voffB[i] = (unsigned)(Rb * K + C) * 2u; }
    const size_t kstep = (size_t)(BK * 2);
    const size_t hstep = (size_t)HALF * K * 2;
    const size_t tstep = 2 * hstep;
    const unsigned ldsw = (unsigned)wid * 1024u;
    const int aoff = lds_byte(wr * 64 + fr, fq * 8), boff = lds_byte(wc * 32 + fr, fq * 8);
#define PG8_SA(b, h) (((b) * 2 + (h)) * HTB)
#define PG8_SB(b, h) ((4 + (b) * 2 + (h)) * HTB)
#define PG8_STAGE(bufoff, gbase, voff) do { _Pragma("unroll") for (int _i = 0; _i < 2; ++_i) \
        __builtin_amdgcn_global_load_lds((const unsigned*)((const char*)(gbase) + (voff)[_i]), (PG8_LAS unsigned*)(lds + (bufoff) + ldsw + _i * 8192), 16, 0, 0); } while (0)
#define PG8_LDA(dst, b, h) do { _Pragma("unroll") for (int m = 0; m < 4; ++m) _Pragma("unroll") for (int k = 0; k < 2; ++k) dst[m][k] = *(const PG8_LAS bf16x8*)(lds + PG8_SA(b, h) + aoff + m * 2048 + k * 1024); } while (0)
#define PG8_LDB(dst, b, h) do { _Pragma("unroll") for (int n = 0; n < 2; ++n) _Pragma("unroll") for (int k = 0; k < 2; ++k) dst[n][k] = *(const PG8_LAS bf16x8*)(lds + PG8_SB(b, h) + boff + n * 2048 + k * 1024); } while (0)
#define PG8_MMA(ai, bj, At, Bt) do { __builtin_amdgcn_s_setprio(1); _Pragma("unroll") for (int m = 0; m < 4; ++m) _Pragma("unroll") for (int n = 0; n < 2; ++n) _Pragma("unroll") for (int k = 0; k < 2; ++k) \
        acc[ai][bj][m][n] = __builtin_amdgcn_mfma_f32_16x16x32_bf16(Bt[n][k], At[m][k], acc[ai][bj][m][n], 0, 0, 0); __builtin_amdgcn_s_setprio(0); } while (0)
#define PG8_WAIT_V(n) asm volatile("s_waitcnt vmcnt(" #n ")" ::: "memory")
#define PG8_WAIT_L(n) asm volatile("s_waitcnt lgkmcnt(" #n ")" ::: "memory")
#define PG8_BAR __builtin_amdgcn_s_barrier()
#define PG8_SCHED __builtin_amdgcn_sched_barrier(0)
    Unit cur, nxt; int ui = 0;
    if (!S.next(0, cur)) return;
    f32x4 acc[2][2][4][2];
#pragma unroll
    for (int a = 0; a < 2; ++a)
#pragma unroll
        for (int b = 0; b < 2; ++b)
#pragma unroll
            for (int m = 0; m < 4; ++m)
#pragma unroll
                for (int n = 0; n < 2; ++n) acc[a][b][m][n] = (f32x4){0.f, 0.f, 0.f, 0.f};
    bf16x8 At[4][2], B0[2][2], B1[2][2];
    const char* cA = (const char*)g.A + (size_t)cur.pm * tstep; const char* cB = (const char*)g.Bt + (size_t)cur.pn * tstep;
    S.a_ready(cur);
    if constexpr (SP2) {
        PG8_STAGE(PG8_SB(0, 0), cB, voffB); PG8_STAGE(PG8_SB(0, 1), cB + hstep, voffB); PG8_STAGE(PG8_SA(0, 0), cA, voffA); PG8_STAGE(PG8_SA(0, 1), cA + hstep, voffA);
        if (wr == 1) PG8_BAR;
        PG8_WAIT_V(2); PG8_BAR;
        PG8_STAGE(PG8_SB(1, 0), cB + kstep, voffB); PG8_STAGE(PG8_SA(1, 0), cA + kstep, voffA); PG8_STAGE(PG8_SB(1, 1), cB + hstep + kstep, voffB);
        PG8_WAIT_V(6); PG8_BAR;
    } else {
        PG8_STAGE(PG8_SB(0, 0), cB, voffB); PG8_STAGE(PG8_SA(0, 0), cA, voffA); PG8_STAGE(PG8_SB(0, 1), cB + hstep, voffB); PG8_STAGE(PG8_SA(0, 1), cA + hstep, voffA);
        if (wr == 1) PG8_BAR;
        PG8_WAIT_V(4); PG8_BAR;
        PG8_STAGE(PG8_SB(1, 0), cB + kstep, voffB); PG8_STAGE(PG8_SA(1, 0), cA + kstep, voffA); PG8_STAGE(PG8_SB(1, 1), cB + hstep + kstep, voffB);
        PG8_WAIT_V(6); PG8_BAR;
    }
    for (;;) {
        const bool has_next = S.next(ui + 1, nxt);
        const char* nA = has_next ? (const char*)g.A + (size_t)nxt.pm * tstep : cA; const char* nB = has_next ? (const char*)g.Bt + (size_t)nxt.pn * tstep : cB;
        for (int t = 0; t < nt; t += 2) {
            const bool last = (t == nt - 2);
            const char* a1 = cA + (size_t)(t + 1) * kstep;
            const char* a2 = last ? nA : cA + (size_t)(t + 2) * kstep; const char* b2 = last ? nB : cB + (size_t)(t + 2) * kstep;
            const char* a3 = a2 + kstep; const char* b3 = b2 + kstep;
            if (last && has_next) S.a_ready(nxt);
            if constexpr (SP2) {
            PG8_LDB(B0, 0, 0); PG8_LDB(B1, 0, 1); PG8_SCHED; PG8_LDA(At, 0, 0); PG8_STAGE(PG8_SA(1, 1), a1 + hstep, voffA);
            PG8_WAIT_V(8); PG8_WAIT_L(0); PG8_BAR; PG8_MMA(0, 0, At, B0); PG8_MMA(0, 1, At, B1); PG8_BAR; PG8_SCHED;
            PG8_LDA(At, 0, 1); PG8_STAGE(PG8_SB(0, 0), b2, voffB); PG8_STAGE(PG8_SB(0, 1), b2 + hstep, voffB); PG8_STAGE(PG8_SA(0, 0), a2, voffA);
            PG8_WAIT_V(8); PG8_WAIT_L(0); PG8_BAR; PG8_MMA(1, 0, At, B0); PG8_MMA(1, 1, At, B1); PG8_BAR; PG8_SCHED;
            PG8_LDB(B0, 1, 0); PG8_LDB(B1, 1, 1); PG8_SCHED; PG8_LDA(At, 1, 0); PG8_STAGE(PG8_SA(0, 1), a2 + hstep, voffA);
            PG8_WAIT_V(8); PG8_WAIT_L(0); PG8_BAR; PG8_MMA(0, 0, At, B0); PG8_MMA(0, 1, At, B1); PG8_BAR; PG8_SCHED;
            PG8_LDA(At, 1, 1); PG8_STAGE(PG8_SB(1, 0), b3, voffB); PG8_STAGE(PG8_SB(1, 1), b3 + hstep, voffB); PG8_STAGE(PG8_SA(1, 0), a3, voffA);
            PG8_WAIT_V(8); PG8_WAIT_L(0); PG8_BAR; PG8_MMA(1, 0, At, B0); PG8_MMA(1, 1, At, B1); PG8_BAR; PG8_SCHED;
            } else {
            PG8_LDB(B0, 0, 0); PG8_SCHED; PG8_LDA(At, 0, 0); PG8_STAGE(PG8_SA(1, 1), a1 + hstep, voffA);
            PG8_WAIT_L(8); PG8_BAR; PG8_WAIT_L(0); PG8_MMA(0, 0, At, B0); PG8_BAR; PG8_SCHED;
            PG8_LDB(B1, 0, 1); PG8_STAGE(PG8_SB(0, 0), b2, voffB);
            PG8_BAR; PG8_WAIT_L(0); PG8_MMA(0, 1, At, B1); PG8_BAR;
            PG8_LDA(At, 0, 1); PG8_STAGE(PG8_SA(0, 0), a2, voffA);
            PG8_BAR; PG8_WAIT_L(0); PG8_MMA(1, 0, At, B0); PG8_BAR; PG8_SCHED;
            PG8_STAGE(PG8_SB(0, 1), b2 + hstep, voffB);
            PG8_WAIT_V(6); PG8_BAR; PG8_MMA(1, 1, At, B1); PG8_BAR;
            PG8_LDB(B0, 1, 0); PG8_SCHED; PG8_LDA(At, 1, 0); PG8_STAGE(PG8_SA(0, 1), a2 + hstep, voffA);
            PG8_WAIT_L(8); PG8_BAR; PG8_WAIT_L(0); PG8_MMA(0, 0, At, B0); PG8_BAR; PG8_SCHED;
            PG8_LDB(B1, 1, 1); PG8_STAGE(PG8_SB(1, 0), b3, voffB);
            PG8_BAR; PG8_WAIT_L(0); PG8_MMA(0, 1, At, B1); PG8_BAR;
            PG8_LDA(At, 1, 1); PG8_STAGE(PG8_SA(1, 0), a3, voffA);
            PG8_BAR; PG8_WAIT_L(0); PG8_MMA(1, 0, At, B0); PG8_BAR; PG8_SCHED;
            PG8_STAGE(PG8_SB(1, 1), b3 + hstep, voffB);
            PG8_WAIT_V(6); PG8_BAR; PG8_MMA(1, 1, At, B1); PG8_BAR;
            }
        }
        if constexpr (ALIGN_EPI) { if (wr == 0) PG8_BAR; }
        if constexpr (!Epi::AFTER_DRAIN) { E(acc, cur, wr, wc, fr, fq); S.done(cur); }
        if (!has_next) break;
#pragma unroll
        for (int a = 0; a < 2; ++a)
#pragma unroll
            for (int b = 0; b < 2; ++b)
#pragma unroll
                for (int m = 0; m < 4; ++m)
#pragma unroll
                    for (int n = 0; n < 2; ++n) acc[a][b][m][n] = (f32x4){0.f, 0.f, 0.f, 0.f};
        cur = nxt; cA = nA; cB = nB; ++ui;
        if constexpr (ALIGN_EPI) { if (wr == 1) PG8_BAR; }
    }
    PG8_WAIT_V(0);
    if constexpr (!ALIGN_EPI) { if (wr == 0) PG8_BAR; }
    PG8_BAR;
    if constexpr (Epi::AFTER_DRAIN) { E.fused(acc, cur, wr, wc, fr, fq, lds, wid, lane); S.done(cur); }
#undef PG8_SA
#undef PG8_SB
#undef PG8_STAGE
#undef PG8_LDA
#undef PG8_LDB
#undef PG8_MMA
#undef PG8_WAIT_V
#undef PG8_WAIT_L
#undef PG8_BAR
#undef PG8_SCHED
}
}
namespace att {
using bf16 = __hip_bfloat16;
constexpr int D = 128, NW = 8, QBLK = 32, KVBLK = 64;
constexpr float SCALE = 0.088388347648318440f;
constexpr float THR = 8.f;
constexpr int SDEPTH = 2;
constexpr int LDQ = 1024, LDK = 256, LDO = 1024;
constexpr size_t SHM_V = KVBLK * D * 2, SHM_K = KVBLK * D * 2, SHM_ATTN = 2 * SHM_V + 2 * SHM_K + NW * 64 * 4;
using bf16x8 = __attribute__((ext_vector_type(8))) short;
using s16x4  = __attribute__((ext_vector_type(4))) short;
using f32x16 = __attribute__((ext_vector_type(16))) float;
using f32x8  = __attribute__((ext_vector_type(8))) float;
using u32x4  = __attribute__((ext_vector_type(4))) unsigned;
#define KSWZ(row, colB) ((row) * 256 + ((colB) ^ (((row) & 7) << 4)))
#define SBAR() __builtin_amdgcn_sched_barrier(0)
__device__ __forceinline__ int crow(int r, int hi) { return (r & 3) + 8 * (r >> 2) + 4 * hi; }
__device__ __forceinline__ unsigned cvtpk(float lo, float hi) {
  unsigned r; asm volatile("v_cvt_pk_bf16_f32 %0, %1, %2" : "=v"(r) : "v"(lo), "v"(hi)); return r;
}
template <typename TIn> struct Stage;
template <> struct Stage<bf16>  { using T = bf16x8;
  __device__ static __forceinline__ T ld8(const bf16* p) { return *reinterpret_cast<const bf16x8*>(p); }
  __device__ static __forceinline__ bf16x8 tobf(T x) { return x; } };
template <> struct Stage<float> { using T = f32x8;
  __device__ static __forceinline__ T ld8(const float* p) { return *reinterpret_cast<const f32x8*>(p); }
  __device__ static __forceinline__ bf16x8 tobf(T x) {
    u32x4 w = {cvtpk(x[0], x[1]), cvtpk(x[2], x[3]), cvtpk(x[4], x[5]), cvtpk(x[6], x[7])}; return *reinterpret_cast<bf16x8*>(&w); } };

__device__ __forceinline__ void partialSM(f32x16& p0, f32x16& p1, float& m_reg, float& mn, float& alpha) {
  constexpr float C = SCALE * 1.4426950408889634f;
  float pmax = p0[0]; for (int r = 1; r < 16; ++r) pmax = fmaxf(pmax, p0[r]); for (int r = 0; r < 16; ++r) pmax = fmaxf(pmax, p1[r]);
  { auto rr = __builtin_amdgcn_permlane32_swap(__float_as_uint(pmax), __float_as_uint(pmax), false, false);
    pmax = fmaxf(__uint_as_float(rr[0]), __uint_as_float(rr[1])); }
  if (__builtin_expect(__all(pmax - m_reg <= THR / SCALE), 1)) { mn = m_reg; alpha = 1.f; }
  else { mn = fmaxf(m_reg, pmax); alpha = __builtin_amdgcn_exp2f((m_reg - mn) * C); m_reg = mn; }
  float mnC = -mn * C;
  for (int r = 0; r < 16; ++r) p0[r] = fmaf(p0[r], C, mnC); for (int r = 0; r < 16; ++r) p1[r] = fmaf(p1[r], C, mnC);
  for (int r = 0; r < 16; ++r) p0[r] = __builtin_amdgcn_exp2f(p0[r]);
}
__device__ __forceinline__ void finishSM(f32x16& p0, f32x16& p1, float alpha, float& l_reg, bf16x8& pa0, bf16x8& pa1, bf16x8& pa2, bf16x8& pa3) {
  for (int r = 0; r < 16; ++r) p1[r] = __builtin_amdgcn_exp2f(p1[r]);
  float ps = 0; for (int r = 0; r < 16; ++r) ps += p0[r]; for (int r = 0; r < 16; ++r) ps += p1[r];
  { auto rr = __builtin_amdgcn_permlane32_swap(__float_as_uint(ps), __float_as_uint(ps), false, false);
    ps = __uint_as_float(rr[0]) + __uint_as_float(rr[1]); }
  l_reg = l_reg * alpha + ps;
#define PK4(P, BASE, OUT) do { unsigned a0 = cvtpk(P[BASE + 0], P[BASE + 1]), a1 = cvtpk(P[BASE + 2], P[BASE + 3]);   \
    unsigned b0 = cvtpk(P[BASE + 4], P[BASE + 5]), b1 = cvtpk(P[BASE + 6], P[BASE + 7]);                              \
    auto r0 = __builtin_amdgcn_permlane32_swap(a0, b0, false, false); auto r1 = __builtin_amdgcn_permlane32_swap(a1, b1, false, false); \
    u32x4 w = {r0[0], r1[0], r0[1], r1[1]}; OUT = *reinterpret_cast<bf16x8*>(&w); } while (0)
  PK4(p0, 0, pa0); PK4(p0, 8, pa1); PK4(p1, 0, pa2); PK4(p1, 8, pa3);
#undef PK4
}
__device__ __forceinline__ void qkt(f32x16& p0, f32x16& p1, const bf16* Ks, const bf16x8* qr, int r32, int hi) {
  p0 = f32x16{}; p1 = f32x16{};
  for (int d0 = 0; d0 < 8; ++d0) { int cb = (d0 * 16 + hi * 8) * 2;
    bf16x8 b0 = *reinterpret_cast<const bf16x8*>((const char*)Ks + KSWZ(r32, cb));
    bf16x8 b1 = *reinterpret_cast<const bf16x8*>((const char*)Ks + KSWZ(32 + r32, cb));
    p0 = __builtin_amdgcn_mfma_f32_32x32x16_bf16(b0, qr[d0], p0, 0, 0, 0);
    p1 = __builtin_amdgcn_mfma_f32_32x32x16_bf16(b1, qr[d0], p1, 0, 0, 0); }
}
__device__ __forceinline__ int v_st(int k, int c) { const int kk = (k & ~0xC) | ((k & 4) << 1) | ((k & 8) >> 1); return ((kk >> 3) * 4 + (c >> 5)) * 512 + ((kk & 7) * 32 + (c & 31)) * 2; }
__device__ __forceinline__ int v_rd_base(int lane) { return ((lane & 3) << 3) | (((lane >> 2) & 3) << 6) | (((lane >> 4) & 1) << 5) | (((lane >> 5) & 1) << 8); }
constexpr int v_rd_off(int d0, int ks, int half) { return d0 * 512 + ks * 4096 + half * 2048; }
template <int OFF> __device__ __forceinline__ s16x4 tr_read(int vb) {
  s16x4 r; asm volatile("ds_read_b64_tr_b16 %0, %1 offset:%2" : "=&v"(r) : "v"(vb), "i"(OFF) : "memory"); return r;
}
template <int D0> __device__ __forceinline__ void pv_one(f32x16& od, int vb, bf16x8 pa0, bf16x8 pa1, bf16x8 pa2, bf16x8 pa3) {
  const s16x4 l0 = tr_read<v_rd_off(D0, 0, 0)>(vb), h0 = tr_read<v_rd_off(D0, 0, 1)>(vb), l1 = tr_read<v_rd_off(D0, 1, 0)>(vb), h1 = tr_read<v_rd_off(D0, 1, 1)>(vb);
  const s16x4 l2 = tr_read<v_rd_off(D0, 2, 0)>(vb), h2 = tr_read<v_rd_off(D0, 2, 1)>(vb), l3 = tr_read<v_rd_off(D0, 3, 0)>(vb), h3 = tr_read<v_rd_off(D0, 3, 1)>(vb);
  asm volatile("s_waitcnt lgkmcnt(0)" ::: "memory"); SBAR();
#define PK(L, H) (bf16x8){L[0], L[1], L[2], L[3], H[0], H[1], H[2], H[3]}
  od = __builtin_amdgcn_mfma_f32_32x32x16_bf16(pa0, PK(l0, h0), od, 0, 0, 0);
  od = __builtin_amdgcn_mfma_f32_32x32x16_bf16(pa1, PK(l1, h1), od, 0, 0, 0);
  od = __builtin_amdgcn_mfma_f32_32x32x16_bf16(pa2, PK(l2, h2), od, 0, 0, 0);
  od = __builtin_amdgcn_mfma_f32_32x32x16_bf16(pa3, PK(l3, h3), od, 0, 0, 0);
#undef PK
}
__device__ __forceinline__ void pv_d0(f32x16* o, int vb, bf16x8 pa0, bf16x8 pa1, bf16x8 pa2, bf16x8 pa3) {
  pv_one<0>(o[0], vb, pa0, pa1, pa2, pa3); pv_one<1>(o[1], vb, pa0, pa1, pa2, pa3); pv_one<2>(o[2], vb, pa0, pa1, pa2, pa3); pv_one<3>(o[3], vb, pa0, pa1, pa2, pa3);
}
template <typename TQ>
__device__ __forceinline__ void attn_dense_body(const TQ* Qb, const bf16* __restrict__ Kh, const bf16* __restrict__ Vh,
                                                bf16* Ob, int seq, char* lds) {
  using St = Stage<bf16>; using SQ = Stage<TQ>;
  const int tid = threadIdx.x, wid = tid >> 6, lane = tid & 63, r32 = lane & 31, hi = lane >> 5;
  bf16* V_lds = (bf16*)lds; bf16* K_lds = (bf16*)(lds + 2 * SHM_V);
  float* ws = (float*)(lds + 2 * SHM_V + 2 * SHM_K) + wid * 64; float* li_l = ws; float* al_l = ws + 32;
  float m_reg = -1e30f, l_reg = 0; f32x16 o[4] = {}; bf16x8 qr[8];
  const TQ* Qw = Qb + (long)(wid * QBLK + r32) * LDQ + hi * 8;
#pragma unroll
  for (int d0 = 0; d0 < 8; ++d0) qr[d0] = SQ::tobf(SQ::ld8(Qw + d0 * 16));
  const int sr = tid >> 4, sc = (tid & 15) * 8, vst0 = v_st(sr, sc), vst1 = v_st(32 + sr, sc);
  const int vb0 = (int)(uintptr_t)V_lds + v_rd_base(lane);
  struct { typename St::T vs0, vs1, ks0, ks1; } sr_[SDEPTH];
#define SLOAD(i, k0) do { sr_[i].vs0 = St::ld8(&Vh[(long)((k0) + sr) * LDK + sc]); sr_[i].vs1 = St::ld8(&Vh[(long)((k0) + 32 + sr) * LDK + sc]); \
    sr_[i].ks0 = St::ld8(&Kh[(long)((k0) + sr) * LDK + sc]); sr_[i].ks1 = St::ld8(&Kh[(long)((k0) + 32 + sr) * LDK + sc]); } while (0)
#define SWRITE(b, i) do { *(bf16x8*)((char*)V_lds + (b) * SHM_V + vst0) = St::tobf(sr_[i].vs0);          \
    *(bf16x8*)((char*)V_lds + (b) * SHM_V + vst1) = St::tobf(sr_[i].vs1); int kc = sc * 2;               \
    *(bf16x8*)((char*)K_lds + (b) * SHM_K + KSWZ(sr, kc)) = St::tobf(sr_[i].ks0);                       \
    *(bf16x8*)((char*)K_lds + (b) * SHM_K + KSWZ(32 + sr, kc)) = St::tobf(sr_[i].ks1); } while (0)
#define SWAIT() do { if constexpr (SDEPTH == 2) asm volatile("s_waitcnt vmcnt(4)" ::: "memory"); else asm volatile("s_waitcnt vmcnt(0)" ::: "memory"); } while (0)
#define RESC(a) do { if (__any((a) < 1.f)) { if (hi == 0) al_l[r32] = (a); asm volatile("s_waitcnt lgkmcnt(0)" ::: "memory"); \
    for (int d = 0; d < 4; ++d) for (int r = 0; r < 16; ++r) o[d][r] *= al_l[crow(r, hi)]; } } while (0)
  f32x16 pA0, pA1, pB0, pB1; float mnA, mnB, alA, alB; bf16x8 pa0, pa1, pa2, pa3; const int NT = seq / KVBLK;
  constexpr int SE = 0, SO = SDEPTH - 1;
  SLOAD(SE, 0); asm volatile("s_waitcnt vmcnt(0)" ::: "memory"); SWRITE(0, SE); __syncthreads();
  qkt(pA0, pA1, K_lds, qr, r32, hi); partialSM(pA0, pA1, m_reg, mnA, alA);
  SLOAD(SO, KVBLK); if constexpr (SDEPTH == 2) { if (2 < NT) SLOAD(SE, 2 * KVBLK); }
  SWAIT(); SWRITE(1, SO); __syncthreads();
  for (int j = 1; j + 1 < NT; j += 2) {
    SBAR(); qkt(pB0, pB1, (bf16*)((char*)K_lds + SHM_K), qr, r32, hi);
    finishSM(pA0, pA1, alA, l_reg, pa0, pa1, pa2, pa3); SBAR();
    SLOAD(SO, (j + SDEPTH) * KVBLK); SBAR();
    pv_d0(o, vb0, pa0, pa1, pa2, pa3); partialSM(pB0, pB1, m_reg, mnB, alB);
    __syncthreads(); SWAIT(); SWRITE(0, SE);
    RESC(alB); __syncthreads();
    SBAR(); qkt(pA0, pA1, K_lds, qr, r32, hi);
    finishSM(pB0, pB1, alB, l_reg, pa0, pa1, pa2, pa3); SBAR();
    if (SDEPTH == 1 || j + 3 < NT) SLOAD(SE, (j + 1 + SDEPTH) * KVBLK); SBAR();
    pv_d0(o, vb0 + (int)SHM_V, pa0, pa1, pa2, pa3); partialSM(pA0, pA1, m_reg, mnA, alA);
    __syncthreads(); SWAIT(); SWRITE(1, SO);
    RESC(alA); __syncthreads();
  }
  SBAR(); qkt(pB0, pB1, (bf16*)((char*)K_lds + SHM_K), qr, r32, hi);
  finishSM(pA0, pA1, alA, l_reg, pa0, pa1, pa2, pa3); SBAR();
  pv_d0(o, vb0, pa0, pa1, pa2, pa3); partialSM(pB0, pB1, m_reg, mnB, alB);
  __syncthreads(); RESC(alB);
  finishSM(pB0, pB1, alB, l_reg, pa0, pa1, pa2, pa3); SBAR();
  pv_d0(o, vb0 + (int)SHM_V, pa0, pa1, pa2, pa3);
  if (hi == 0) li_l[r32] = l_reg; asm volatile("s_waitcnt lgkmcnt(0)" ::: "memory");
  float rli[16];
#pragma unroll
  for (int r = 0; r < 16; ++r) rli[r] = __builtin_amdgcn_rcpf(li_l[crow(r, hi)]);
  bf16* Ow = Ob + (long)(wid * QBLK) * LDO;
#pragma unroll
  for (int r = 0; r < 16; ++r) { int orow = crow(r, hi);
    for (int d0 = 0; d0 < 4; ++d0) Ow[(long)orow * LDO + d0 * 32 + r32] = __float2bfloat16(o[d0][r] * rli[r]); }
#undef SLOAD
#undef SWRITE
#undef SWAIT
#undef RESC
}
#undef KSWZ
#undef SBAR
}
#ifndef MK_LAUNCHES
#define MK_LAUNCHES 1
#endif
constexpr int NWAVES = 8, NPHASE = 13;
constexpr int MTOK = 32768, MPROMPT = 16384, FFH = 2816;
constexpr size_t MiB = 1u << 20;
constexpr size_t WS_ROPE = 0;
constexpr size_t WS_SS1 = 65536;
constexpr size_t WS_WF1 = MiB / 2;
constexpr size_t WS_A = WS_WF1 + 11 * MiB;
constexpr size_t WS_B = WS_A + 64 * MiB;
constexpr size_t WS_W1 = WS_B;
constexpr size_t WS_WB = WS_B + 13 * MiB;
constexpr size_t WS_WO = WS_B + 17 * MiB;
constexpr size_t WS_MRG = WS_B + 19 * MiB;
constexpr size_t WS_UQ = WS_B + 83 * MiB;
constexpr size_t WS_H = WS_B;
constexpr size_t WS_END = WS_B + 176 * MiB;
constexpr size_t DO_CB = 0, DO_K = 0, DO_V = 16 * MiB, DO_G = 64 * MiB;
constexpr int LDS_BYTES = 131072;

#define LAS __attribute__((address_space(3)))
typedef unsigned short bf16;
typedef unsigned v4u __attribute__((ext_vector_type(4)));
typedef float f32x4 __attribute__((ext_vector_type(4)));
#define LDS_WAIT() asm volatile("s_waitcnt lgkmcnt(0)" ::: "memory")
__device__ __forceinline__ unsigned f2bf(float f) { unsigned u = __builtin_bit_cast(unsigned, f); return (u + 0x7fffu + ((u >> 16) & 1u)) >> 16; }
__device__ __forceinline__ unsigned pk2(float lo, float hi) { return f2bf(lo) | (f2bf(hi) << 16); }
__device__ __forceinline__ float wave_sum(float v) {
#pragma unroll
    for (int o = 1; o < 64; o <<= 1) v += __shfl_xor(v, o);
    return v;
}
__device__ __forceinline__ void transpose_item(const float* W, int N, bf16* WT, int Kd, int k0, int n0, int drow0, const float* ksc, LAS float* scr, int lane) {
#pragma unroll 8
    for (int i = 0; i < 32; ++i) { const int kk = 2 * i + (lane >> 5); float v = W[(size_t)(k0 + kk) * N + n0 + (lane & 31)]; if (ksc) v *= ksc[k0 + kk]; scr[kk * 33 + (lane & 31)] = v; }
    LDS_WAIT(); asm volatile("" ::: "memory");
    const int c = lane & 7;
#pragma unroll
    for (int j = 0; j < 4; ++j) { const int n = (lane >> 3) + 8 * j; const LAS float* s = scr + (8 * c) * 33 + n;
        v4u o; o.x = pk2(s[0 * 33], s[1 * 33]); o.y = pk2(s[2 * 33], s[3 * 33]); o.z = pk2(s[4 * 33], s[5 * 33]); o.w = pk2(s[6 * 33], s[7 * 33]);
        *(v4u*)(WT + (size_t)(drow0 + n) * Kd + k0 + 8 * c) = o; }
    LDS_WAIT(); asm volatile("" ::: "memory");
}
__device__ __forceinline__ int map_in(int n0) {
    if (n0 < 1024) return 2048 + n0;
    if (n0 < 2048) { const int j = n0 - 1024; return 256 * (j >> 7) + (j & 127); }
    if (n0 < 3072) { const int j = n0 - 2048; return 256 * (j >> 7) + 128 + (j & 127); }
    if (n0 < 4096) return 4096 + (n0 - 3072);
    if (n0 < 4352) return 4096 + 1024 + (n0 - 4096);
    if (n0 < 4608) return 4096 + 1280 + (n0 - 4352);
    if (n0 < 5632) return 3072 + (n0 - 4608);
    return 4096 + 1536 + (n0 - 5632);
}
__device__ __forceinline__ void ld8f(const bf16* p, f32x4& v0, f32x4& v1) { pg8::ld8(p, v0, v1); }

struct Args { const float* in[13]; float* out; unsigned char* ws; int ph_lo, ph_hi; };

__global__ void __launch_bounds__(NWAVES * 64, 2) mk_fwd(Args a) {
    extern __shared__ __attribute__((aligned(16))) unsigned char lds[];
    cg::grid_group grid = cg::this_grid();
    const int tid = threadIdx.x, lane = tid & 63, wave = __builtin_amdgcn_readfirstlane(tid >> 6);
    const int G = gridDim.x, bx = blockIdx.x;
    const int vcu = (G % 8 == 0) ? (bx % 8) * (G / 8) + bx / 8 : bx;
    const int gw = vcu * NWAVES + wave, NGW = G * NWAVES;
    const int gt = vcu * (NWAVES * 64) + tid, NGT = G * NWAVES * 64;
    const int lo = a.ph_lo, hi = a.ph_hi;
    unsigned char* ws = a.ws; unsigned char* ob = (unsigned char*)a.out;
    const float* x_p = a.in[0]; const float* x_s = a.in[1];
    float2* rope = (float2*)(ws + WS_ROPE); float* ss1 = (float*)(ws + WS_SS1);
    bf16* Wf1 = (bf16*)(ws + WS_WF1); bf16* XA = (bf16*)(ws + WS_A); bf16* W1 = (bf16*)(ws + WS_W1); bf16* WB = (bf16*)(ws + WS_WB); bf16* WO = (bf16*)(ws + WS_WO);
    bf16* MRG = (bf16*)(ws + WS_MRG); bf16* UQ = (bf16*)(ws + WS_UQ); bf16* HB = (bf16*)(ws + WS_H);
    bf16* CB = (bf16*)(ob + DO_CB); bf16* KB = (bf16*)(ob + DO_K); bf16* VB = (bf16*)(ob + DO_V); bf16* GB = (bf16*)(ob + DO_G);
    LAS unsigned char* l3 = (LAS unsigned char*)lds;
#define IN(k) (lo <= (k) && (k) < hi)
#define SEAM(k) do { if (lo <= (k) && (k) + 1 < hi) grid.sync(); } while (0)

    if (IN(0)) {
        LAS float* scr = (LAS float*)(l3 + wave * 16384);
        constexpr int I_IN = 16 * 208, I_SQ = 16 * 32, I_F1 = 16 * 176, NITEMS = I_IN + 3 * I_SQ + I_F1;
        for (int it = gw; it < NITEMS; it += NGW) {
            int r = it;
            if (r < I_IN) { const int kb = r / 208, nb = r % 208; transpose_item(a.in[3], 6656, W1, 1024, 64 * kb, 32 * nb, map_in(32 * nb), nullptr, scr, lane); continue; } r -= I_IN;
            if (r < 2 * I_SQ) { const int br = r / I_SQ, q = r % I_SQ, kb = q / 32, nb = q % 32;
                transpose_item(a.in[7] + (size_t)br * 1024 * 1024, 1024, WB + (size_t)br * 1024 * 1024, 1024, 64 * kb, 32 * nb, 32 * nb, nullptr, scr, lane); continue; } r -= 2 * I_SQ;
            if (r < I_SQ) { const int kb = r / 32, nb = r % 32; transpose_item(a.in[8], 1024, WO, 1024, 64 * kb, 32 * nb, 32 * nb, nullptr, scr, lane); continue; } r -= I_SQ;
            { const int kb = r / 176, nb = r % 176, n0 = 32 * nb, up = n0 >= FFH ? 1 : 0, j = n0 - up * FFH;
                transpose_item(a.in[10], 2 * FFH, Wf1, 1024, 64 * kb, n0, 256 * (j >> 7) + 128 * up + (j & 127), a.in[9], scr, lane); }
        }
        {
            const float* g = a.in[2];
            f32x4 gv[4];
#pragma unroll
            for (int j = 0; j < 4; ++j) gv[j] = *(const f32x4*)(g + 4 * lane + 256 * j);
            for (int m = gw; m < MTOK; m += NGW) {
                const float* xr = (m < MPROMPT) ? x_p + (size_t)m * 1024 : x_s + (size_t)(m - MPROMPT) * 1024;
                f32x4 v[4]; float s = 0.f;
#pragma unroll
                for (int j = 0; j < 4; ++j) { v[j] = *(const f32x4*)(xr + 4 * lane + 256 * j); s += (v[j].x * v[j].x + v[j].y * v[j].y) + (v[j].z * v[j].z + v[j].w * v[j].w); }
                const float rstd = 1.0f / sqrtf(wave_sum(s) * (1.0f / 1024.0f) + 1e-6f);
                unsigned long long* o8 = (unsigned long long*)(XA + (size_t)m * 1024) + lane;
#pragma unroll
                for (int j = 0; j < 4; ++j) { const f32x4 y = v[j] * rstd * gv[j]; o8[64 * j] = (unsigned long long)pk2(y.x, y.y) | ((unsigned long long)pk2(y.z, y.w) << 32); }
            }
        }
        if (gt < 8192) {
            const int p = gt >> 5, j = gt & 31;
            const double r = 1.0 / sqrt(sqrt(sqrt(10.0)));
            double f = 1.0; for (int i = 0; i < j; ++i) f *= r;
            const double ang = (double)p * f; const double TWO_PI = 6.283185307179586476925;
            const double q = rint(ang * (1.0 / TWO_PI)); const double rr = ang - q * TWO_PI;
            const double y = rr * 0.125, y2 = y * y;
            double sn = y * (1.0 + y2 * (-1.0 / 6 + y2 * (1.0 / 120 + y2 * (-1.0 / 5040 + y2 * (1.0 / 362880 + y2 * (-1.0 / 39916800 + y2 * (1.0 / 6227020800.0)))))));
            double cs = 1.0 + y2 * (-0.5 + y2 * (1.0 / 24 + y2 * (-1.0 / 720 + y2 * (1.0 / 40320 + y2 * (-1.0 / 3628800 + y2 * (1.0 / 479001600.0 + y2 * (-1.0 / 87178291200.0)))))));
#pragma unroll
            for (int i = 0; i < 3; ++i) { const double s2 = 2.0 * sn * cs, c2 = 1.0 - 2.0 * sn * sn; sn = s2; cs = c2; }
            rope[gt] = make_float2((float)cs, (float)sn);
        }
        for (int i = gt; i < MTOK; i += NGT) ss1[i] = 0.f;
    }
    SEAM(0);

    if (IN(1)) {
        pg8::Gemm g{XA, W1, MTOK, 4096, 1024}; pg8::StaticOrder S; S.init(MTOK, 4096, G, bx);
        pg8::Epi1a E{UQ, CB, GB};
        pg8::gemm_phase<pg8::Epi1a, pg8::StaticOrder, true, true>(l3, g, S, E);
    }
    SEAM(1);

    if (IN(2)) {
        const float* cw = a.in[4];
        for (int it = gt; it < 131072; it += NGT) {
            const int c0 = (it & 127) * 8, m0 = (it >> 7) * 32;
            const f32x4 w0a = *(const f32x4*)(cw + c0), w0b = *(const f32x4*)(cw + c0 + 4), w1a = *(const f32x4*)(cw + 1024 + c0), w1b = *(const f32x4*)(cw + 1024 + c0 + 4),
                        w2a = *(const f32x4*)(cw + 2048 + c0), w2b = *(const f32x4*)(cw + 2048 + c0 + 4);
            const bool first = (m0 < MPROMPT) ? ((m0 & 4095) == 0) : (m0 == MPROMPT);
            f32x4 p0 = {0.f, 0.f, 0.f, 0.f}, p1 = {0.f, 0.f, 0.f, 0.f}, c0v, c1v;
            if (!first) ld8f(UQ + (size_t)(m0 - 1) * 1024 + c0, p0, p1);
            ld8f(UQ + (size_t)m0 * 1024 + c0, c0v, c1v);
#pragma unroll 4
            for (int i = 0; i < 32; ++i) { const int m = m0 + i; const bool last = (m < MPROMPT) ? ((m & 4095) == 4095) : (m == MTOK - 1);
                f32x4 n0 = {0.f, 0.f, 0.f, 0.f}, n1 = {0.f, 0.f, 0.f, 0.f}, b0, b1;
                if (!last) ld8f(UQ + (size_t)(m + 1) * 1024 + c0, n0, n1);
                bf16* cbp = CB + (size_t)m * 1024 + c0; ld8f(cbp, b0, b1);
                const f32x4 y0 = b0 * (w0a * p0 + w1a * c0v + w2a * n0), y1 = b1 * (w0b * p1 + w1b * c1v + w2b * n1);
                pg8::st8(cbp, y0, y1); p0 = c0v; p1 = c1v; c0v = n0; c1v = n1; }
        }
    }
    SEAM(2);

    if (IN(3)) {
        pg8::Gemm g{CB, WB, MTOK, 1024, 1024}; pg8::StaticOrder S; S.init(MTOK, 1024, G, bx);
        pg8::EpiBranch<0> E{GB, MRG};
        pg8::gemm_phase<pg8::EpiBranch<0>, pg8::StaticOrder, true, true>(l3, g, S, E);
    }
    SEAM(3);

    if (IN(4)) {
        pg8::Gemm g{XA, W1 + (size_t)4096 * 1024, MTOK, 2560, 1024}; pg8::StaticOrder S; S.init(MTOK, 2560, G, bx);
        pg8::Epi1b E{UQ, KB, VB, GB};
        pg8::gemm_phase<pg8::Epi1b, pg8::StaticOrder, true, true>(l3, g, S, E);
    }
    SEAM(4);

    if (IN(5)) {
        const float* qg = a.in[5]; const float* kg = a.in[6];
        const float gq0 = qg[2 * lane], gq1 = qg[2 * lane + 1], gk0 = kg[2 * lane], gk1 = kg[2 * lane + 1];
        for (int m = gw; m < MTOK; m += NGW) {
            const int t = (m < MPROMPT) ? (m & 4095) : (m - MPROMPT);
            const float2 cs = (lane < 32) ? rope[(t >> 6) * 32 + lane] : rope[(t & 63) * 32 + lane - 32];
#pragma unroll
            for (int hh = 0; hh < 10; ++hh) {
                unsigned* p = (hh < 8) ? (unsigned*)(UQ + (size_t)m * 1024 + hh * 128) + lane : (unsigned*)(KB + (size_t)m * 256 + (hh - 8) * 128) + lane;
                const unsigned w = *p; const float x0 = __uint_as_float(w << 16), x1 = __uint_as_float(w & 0xffff0000u);
                const float rstd = 1.0f / sqrtf(wave_sum(x0 * x0 + x1 * x1) * (1.0f / 128.0f) + 1e-6f);
                const float y0 = x0 * rstd * (hh < 8 ? gq0 : gk0), y1 = x1 * rstd * (hh < 8 ? gq1 : gk1);
                *p = pk2(y0 * cs.x - y1 * cs.y, y0 * cs.y + y1 * cs.x);
            }
        }
    }
    SEAM(5);

    if (IN(6)) {
        const att::bf16* Kp = (const att::bf16*)KB; const att::bf16* Vp = (const att::bf16*)VB; att::bf16* Qp = (att::bf16*)UQ;
        for (int j = vcu; j < 1024; j += G) {
            const int v = j & 255, i = j >> 8; int rowbase, seq, h, kvh, qb;
            if (i < 2) { kvh = v >> 7; const int idx = (v & 127) * 2 + i; h = kvh * 4 + (idx >> 6); qb = idx & 63; rowbase = MPROMPT; seq = 16384; }
            else { const int grp = v >> 5; kvh = grp & 1; const int idx = (v & 31) * 2 + (i - 2); h = kvh * 4 + (idx >> 4); qb = idx & 15; rowbase = (grp >> 1) * 4096; seq = 4096; }
            att::bf16* qptr = Qp + (size_t)(rowbase + qb * 256) * 1024 + h * 128;
            att::attn_dense_body<att::bf16>(qptr, Kp + (size_t)rowbase * 256 + kvh * 128, Vp + (size_t)rowbase * 256 + kvh * 128, qptr, seq, (char*)lds);
            __syncthreads();
        }
    }
    SEAM(6);

    if (IN(7)) {
        pg8::Gemm g{UQ, WB + (size_t)1024 * 1024, MTOK, 1024, 1024}; pg8::StaticOrder S; S.init(MTOK, 1024, G, bx);
        pg8::EpiBranch<1> E{GB, MRG};
        pg8::gemm_phase<pg8::EpiBranch<1>, pg8::StaticOrder, true, true>(l3, g, S, E);
    }
    SEAM(7);

    if (IN(8)) {
        pg8::Gemm g{MRG, WO, MTOK, 1024, 1024}; pg8::StaticOrder S; S.init(MTOK, 1024, G, bx);
        pg8::EpiRes1 E{x_p, x_s, a.out, XA, ss1};
        pg8::gemm_phase<pg8::EpiRes1, pg8::StaticOrder, true, true>(l3, g, S, E);
    }
    SEAM(8);

    if (IN(9)) {
        pg8::Gemm g{XA, Wf1, MTOK, 2 * FFH, 1024}; pg8::StaticOrder S; S.init(MTOK, 2 * FFH, G, bx);
        pg8::EpiSwiglu E{ss1, HB};
        pg8::gemm_phase<pg8::EpiSwiglu, pg8::StaticOrder, true, true>(l3, g, S, E);
    }
    SEAM(9);

    if (IN(10)) {
        LAS float* scr = (LAS float*)(l3 + wave * 16384);
        for (int it = gw; it < 44 * 32; it += NGW) { const int kb = it / 32, nb = it % 32; transpose_item(a.in[11], 1024, XA, FFH, 64 * kb, 32 * nb, 32 * nb, nullptr, scr, lane); }
    }
    SEAM(10);

    if (IN(11)) {
        pg8::Gemm g{HB, XA, MTOK, 1024, FFH}; pg8::StaticOrder S; S.init(MTOK, 1024, G, bx);
        pg8::EpiRes2 E{a.out};
        pg8::gemm_phase<pg8::EpiRes2, pg8::StaticOrder, true, true>(l3, g, S, E);
    }
    SEAM(11);

    if (IN(12)) {
        const float* g = a.in[12];
        f32x4 gv[4];
#pragma unroll
        for (int j = 0; j < 4; ++j) gv[j] = *(const f32x4*)(g + 4 * lane + 256 * j);
        for (int m = gw; m < MTOK; m += NGW) {
            float* xr = a.out + (size_t)m * 1024;
            f32x4 v[4]; float s = 0.f;
#pragma unroll
            for (int j = 0; j < 4; ++j) { v[j] = *(const f32x4*)(xr + 4 * lane + 256 * j); s += (v[j].x * v[j].x + v[j].y * v[j].y) + (v[j].z * v[j].z + v[j].w * v[j].w); }
            const float rstd = 1.0f / sqrtf(wave_sum(s) * (1.0f / 1024.0f) + 1e-6f);
#pragma unroll
            for (int j = 0; j < 4; ++j) *(f32x4*)(xr + 4 * lane + 256 * j) = v[j] * rstd * gv[j];
        }
    }
#ifdef STAGE_SRC
    if (lo == 96) { const v4u* src = (const v4u*)(STAGE_SRC); v4u* dst = (v4u*)MRG;
        for (size_t i = gt; i < ((size_t)64 << 20) / 16; i += NGT) dst[i] = src[i]; }
#endif
#ifdef DUMP_SRC
    if (lo == 98) { const bf16* src = DUMP_SRC;
        for (size_t i = gt; i < (size_t)MTOK * 1024 / 8; i += NGT) { f32x4 v0, v1; ld8f(src + i * 8, v0, v1); *(f32x4*)(a.out + i * 8) = v0; *(f32x4*)(a.out + i * 8 + 4) = v1; } }
#endif
#ifdef STOP_AFTER
    if (lo == 99) { unsigned* o = (unsigned*)a.out; const unsigned* w = (const unsigned*)ws; const size_t NWD = (size_t)32 << 20;
        for (size_t i = gt; i < NWD; i += NGT) o[i] = o[i] + w[i] + w[i + NWD]; }
#endif
#undef IN
#undef SEAM
}

extern "C" void kernel_launch(void* const* d_in, const int* in_sizes, int n_in, void* d_out, int out_size, void* d_ws, size_t ws_size, hipStream_t stream) {
    static int grid = 0;
    if (grid == 0) {
        if (n_in != 13 || in_sizes[0] != MPROMPT * 1024 || in_sizes[1] != MPROMPT * 1024 || out_size != MTOK * 1024 || ws_size < WS_END) {
            fprintf(stderr, "kernel_launch: unexpected shapes (n_in %d, in0 %d, out %d, ws %zu; need ws >= %zu); nothing launched\n", n_in, n_in > 0 ? in_sizes[0] : -1, out_size, ws_size, (size_t)WS_END);
            grid = -1; return; }
        int dev = 0, cus = 0, per_cu = 0;
        if (hipGetDevice(&dev) != hipSuccess || hipDeviceGetAttribute(&cus, hipDeviceAttributeMultiprocessorCount, dev) != hipSuccess) { fprintf(stderr, "kernel_launch: device query failed\n"); grid = -1; return; }
        if (hipFuncSetAttribute((const void*)mk_fwd, hipFuncAttributeMaxDynamicSharedMemorySize, LDS_BYTES) != hipSuccess) { fprintf(stderr, "kernel_launch: hipFuncSetAttribute failed\n"); grid = -1; return; }
        if (hipOccupancyMaxActiveBlocksPerMultiprocessor(&per_cu, (const void*)mk_fwd, NWAVES * 64, LDS_BYTES) != hipSuccess || per_cu < 1) {
            fprintf(stderr, "kernel_launch: occupancy query says %d blocks per CU; assuming 1\n", per_cu); per_cu = 1; }
        (void)hipGetLastError();
        grid = cus * per_cu;
    }
    if (grid < 0) return;
    Args a{};
    for (int i = 0; i < 13; ++i) a.in[i] = (const float*)d_in[i];
    a.out = (float*)d_out; a.ws = (unsigned char*)d_ws;
#if MK_LAUNCHES == 1
    a.ph_lo = 0; a.ph_hi = NPHASE;
    void* kargs[] = {&a};
    const hipError_t e = hipLaunchCooperativeKernel((const void*)mk_fwd, dim3(grid), dim3(NWAVES * 64), kargs, LDS_BYTES, stream);
    if (e != hipSuccess) fprintf(stderr, "kernel_launch: cooperative launch failed: %s (grid %d)\n", hipGetErrorString(e), grid);
#else
#ifdef STOP_AFTER
    const int nph = STOP_AFTER + 2;
#else
    const int nph = NPHASE;
#endif
    for (int ph0 = 0; ph0 < nph; ++ph0) {
        int ph = ph0;
#ifdef STOP_AFTER
#ifdef STAGE_SRC
        if (ph0 == STOP_AFTER + 1) { a.ph_lo = 96; a.ph_hi = 97; hipLaunchKernelGGL(mk_fwd, dim3(grid), dim3(NWAVES * 64), LDS_BYTES, stream, a); }
#endif
#ifdef DUMP_SRC
        if (ph0 == STOP_AFTER + 1) ph = 98;
#else
        if (ph0 == STOP_AFTER + 1) ph = 99;
#endif
#endif
        a.ph_lo = ph; a.ph_hi = ph + 1;
        hipLaunchKernelGGL(mk_fwd, dim3(grid), dim3(NWAVES * 64), LDS_BYTES, stream, a);
        const hipError_t le = hipPeekAtLastError();
        if (le != hipSuccess) { fprintf(stderr, "kernel_launch: launch %d failed: %s\n", ph, hipGetErrorName(le)); break; }
    }
#endif
}
```
